# Optimizing an MI355X kernel written in HIP

```python
import jax, jax.numpy as jnp
from jax import lax
import numpy as np

D_MODEL = 1024
BATCH = 2
SEQ = 8192
DEPTH = 1

N_HEADS = 8
QK_NOPE_DIM = 64
QK_ROPE_DIM = 32
QK_DIM = QK_NOPE_DIM + QK_ROPE_DIM
V_DIM = 64
Q_LORA = 256
KV_LORA = 256
ROPE_THETA = 10000.0
Q_BLOCK = 128
F_GROUPS = 4
F_GROUP_DIM = 128
F_DIM = F_GROUPS * F_GROUP_DIM
N_BRANCH = 2
IN_DIM = Q_LORA + KV_LORA + QK_ROPE_DIM + F_DIM + N_BRANCH * D_MODEL
SPLITS = (Q_LORA, Q_LORA + KV_LORA, Q_LORA + KV_LORA + QK_ROPE_DIM, Q_LORA + KV_LORA + QK_ROPE_DIM + F_DIM)
PEER_HEADS = 8
PEER_NKEYS = 128
PEER_EXPERTS = PEER_NKEYS * PEER_NKEYS
PEER_QDIM = 256
PEER_HALF = PEER_QDIM // 2
PEER_TOPK = 16
PEER_CHUNK = 128
DN_ALPHA = (2.0 * DEPTH) ** 0.25
DN_BETA = (8.0 * DEPTH) ** -0.25
LN_EPS = 1e-5
RMS_EPS = 1e-6

kernel_name = "hybrid_mla_fnet_peer_deepnorm_encoder"


def layer_norm(x, g, b):
    xf = x.astype(jnp.float32)
    mu = jnp.mean(xf, axis=-1, keepdims=True)
    var = jnp.mean(jnp.square(xf - mu), axis=-1, keepdims=True)
    y = (xf - mu) * lax.rsqrt(var + LN_EPS) * g.astype(jnp.float32) + b.astype(jnp.float32)
    return y.astype(x.dtype)


def rms_norm(x, g):
    xf = x.astype(jnp.float32)
    y = xf * lax.rsqrt(jnp.mean(jnp.square(xf), axis=-1, keepdims=True) + RMS_EPS) * g.astype(jnp.float32)
    return y.astype(x.dtype)


def rotary_tables(seq_len):
    pos = jnp.arange(seq_len, dtype=jnp.float32)
    inv = 1.0 / (ROPE_THETA ** (jnp.arange(0, QK_ROPE_DIM, 2, dtype=jnp.float32) / QK_ROPE_DIM))
    ang = pos[:, None] * inv[None, :]
    return jnp.cos(ang), jnp.sin(ang)


def apply_rope(x, cos, sin):
    xf = x.astype(jnp.float32)
    half = QK_ROPE_DIM // 2
    x1, x2 = xf[..., :half], xf[..., half:]
    return jnp.concatenate([x1 * cos - x2 * sin, x2 * cos + x1 * sin], axis=-1).astype(x.dtype)


def mla_branch(c_q, c_kv, k_rope_raw, q_norm_g, kv_norm_g, w_uq, w_uk, w_uv, w_o_attn, cos, sin):
    B, S, _ = c_q.shape
    q = (rms_norm(c_q, q_norm_g) @ w_uq).reshape(B, S, N_HEADS, QK_DIM) * (QK_DIM ** -0.5)
    q_nope = q[..., :QK_NOPE_DIM]
    q_rope = apply_rope(q[..., QK_NOPE_DIM:], cos[None, :, None, :], sin[None, :, None, :])
    c = rms_norm(c_kv, kv_norm_g)
    k_nope = (c @ w_uk).reshape(B, S, N_HEADS, QK_NOPE_DIM)
    v = (c @ w_uv).reshape(B, S, N_HEADS, V_DIM)
    k_rope = apply_rope(k_rope_raw, cos[None], sin[None])
    nb = S // Q_BLOCK
    qn_blocks = q_nope.reshape(B, nb, Q_BLOCK, N_HEADS, QK_NOPE_DIM).transpose(1, 0, 2, 3, 4)
    qr_blocks = q_rope.reshape(B, nb, Q_BLOCK, N_HEADS, QK_ROPE_DIM).transpose(1, 0, 2, 3, 4)

    def attend(blk):
        qn, qr = blk
        s = (jnp.einsum('bqhd,bkhd->bhqk', qn, k_nope, preferred_element_type=jnp.float32)
             + jnp.einsum('bqhr,bkr->bhqk', qr, k_rope, preferred_element_type=jnp.float32))
        p = jax.nn.softmax(s, axis=-1).astype(v.dtype)
        return jnp.einsum('bhqk,bkhd->bqhd', p, v)

    o = lax.map(attend, (qn_blocks, qr_blocks))
    o = o.transpose(1, 0, 2, 3, 4).reshape(B, S, N_HEADS * V_DIM)
    return o @ w_o_attn


def fourier_branch(z, w_fourier):
    B, S, _ = z.shape
    zf = z.astype(jnp.float32).reshape(B, S, F_GROUPS, F_GROUP_DIM)
    y = jnp.fft.fft2(zf, axes=(1, 3), norm='ortho').real
    return y.astype(z.dtype).reshape(B, S, F_DIM) @ w_fourier


def peer(x, w_q, keys, w_u, w_v):
    B, S, D = x.shape
    T = B * S
    xt = x.reshape(T, D)
    q = (xt @ w_q).reshape(T, PEER_HEADS, 2, PEER_HALF)
    s_half = jnp.einsum('thcd,hcnd->thcn', q, keys, preferred_element_type=jnp.float32)
    sv, si = lax.top_k(s_half, PEER_TOPK)
    cand = (sv[:, :, 0, :, None] + sv[:, :, 1, None, :]).reshape(T, PEER_HEADS, PEER_TOPK * PEER_TOPK)
    cv, ci = lax.top_k(cand, PEER_TOPK)
    ia = jnp.take_along_axis(si[:, :, 0], ci // PEER_TOPK, axis=-1)
    ib = jnp.take_along_axis(si[:, :, 1], ci % PEER_TOPK, axis=-1)
    expert = (ia * PEER_NKEYS + ib).reshape(T, PEER_HEADS * PEER_TOPK)
    gate = jax.nn.softmax(cv, axis=-1).reshape(T, PEER_HEADS * PEER_TOPK)
    nc = T // PEER_CHUNK
    hk = PEER_HEADS * PEER_TOPK

    def run(blk):
        xc, ec, gc = blk
        u = jnp.take(w_u, ec, axis=0)
        h = jnp.einsum('cd,ced->ce', xc, u, preferred_element_type=jnp.float32)
        a = (jax.nn.gelu(h, approximate=False) * gc).astype(x.dtype)
        return jnp.einsum('ce,ced->cd', a, jnp.take(w_v, ec, axis=0))

    y = lax.map(run, (xt.reshape(nc, PEER_CHUNK, D), expert.reshape(nc, PEER_CHUNK, hk), gate.reshape(nc, PEER_CHUNK, hk)))
    return y.reshape(B, S, D)


def setup_inputs(seed: int = 0) -> dict:
    key = jax.random.key(seed)
    ks = jax.random.split(key, 24)
    f32 = jnp.float32

    def nrm(k, shape, scale):
        return jax.random.normal(k, shape, f32) * scale

    L = DEPTH
    return {
        'x': nrm(ks[0], (BATCH, SEQ, D_MODEL), 1.0),
        'ln0_g': 1.0 + nrm(ks[1], (D_MODEL,), 0.02),
        'ln0_b': nrm(ks[2], (D_MODEL,), 0.02),
        'w_in': nrm(ks[3], (L, D_MODEL, IN_DIM), D_MODEL ** -0.5),
        'b_in': nrm(ks[4], (L, IN_DIM), 0.02),
        'q_norm_g': 1.0 + nrm(ks[5], (L, Q_LORA), 0.02),
        'kv_norm_g': 1.0 + nrm(ks[6], (L, KV_LORA), 0.02),
        'w_uq': nrm(ks[7], (L, Q_LORA, N_HEADS * QK_DIM), Q_LORA ** -0.5),
        'w_uk': nrm(ks[8], (L, KV_LORA, N_HEADS * QK_NOPE_DIM), KV_LORA ** -0.5),
        'w_uv': nrm(ks[9], (L, KV_LORA, N_HEADS * V_DIM), DN_BETA * KV_LORA ** -0.5),
        'w_o_attn': nrm(ks[10], (L, N_HEADS * V_DIM, D_MODEL), (N_HEADS * V_DIM) ** -0.5),
        'w_fourier': nrm(ks[11], (L, F_DIM, D_MODEL), DN_BETA * F_DIM ** -0.5),
        'w_out': nrm(ks[12], (L, D_MODEL, D_MODEL), DN_BETA * D_MODEL ** -0.5),
        'b_out': nrm(ks[13], (L, D_MODEL), 0.02),
        'ln1_g': 1.0 + nrm(ks[14], (L, D_MODEL), 0.02),
        'ln1_b': nrm(ks[15], (L, D_MODEL), 0.02),
        'peer_w_q': nrm(ks[16], (L, D_MODEL, PEER_HEADS * PEER_QDIM), D_MODEL ** -0.5),
        'peer_keys': nrm(ks[17], (L, PEER_HEADS, 2, PEER_NKEYS, PEER_HALF), PEER_HALF ** -0.5),
        'peer_w_u': nrm(ks[18], (L, PEER_EXPERTS, D_MODEL), D_MODEL ** -0.5),
        'peer_w_v': nrm(ks[19], (L, PEER_EXPERTS, D_MODEL), DN_BETA),
        'ln2_g': 1.0 + nrm(ks[20], (L, D_MODEL), 0.02),
        'ln2_b': nrm(ks[21], (L, D_MODEL), 0.02),
    }


def reference(x, ln0_g, ln0_b, w_in, b_in, q_norm_g, kv_norm_g, w_uq, w_uk, w_uv, w_o_attn, w_fourier,
              w_out, b_out, ln1_g, ln1_b, peer_w_q, peer_keys, peer_w_u, peer_w_v, ln2_g, ln2_b):
    B, S, D = x.shape
    cos, sin = rotary_tables(S)
    h = layer_norm(x, ln0_g, ln0_b)
    for l in range(DEPTH):
        p = h @ w_in[l] + b_in[l]
        c_q, c_kv, k_r, z_f, g_logits = jnp.split(p, SPLITS, axis=-1)
        y_a = mla_branch(c_q, c_kv, k_r, q_norm_g[l], kv_norm_g[l], w_uq[l], w_uk[l], w_uv[l], w_o_attn[l], cos, sin)
        y_f = fourier_branch(z_f, w_fourier[l])
        g = jax.nn.sigmoid(g_logits.astype(jnp.float32)).astype(h.dtype).reshape(B, S, N_BRANCH, D)
        m = g[:, :, 0, :] * y_a + g[:, :, 1, :] * y_f
        h = layer_norm(DN_ALPHA * h + (m @ w_out[l] + b_out[l]), ln1_g[l], ln1_b[l])
        h = layer_norm(DN_ALPHA * h + peer(h, peer_w_q[l], peer_keys[l], peer_w_u[l], peer_w_v[l]), ln2_g[l], ln2_b[l])
    return h
```

```cpp
#include <hip/hip_runtime.h>
#include <stdint.h>

typedef unsigned short bf16_t;

constexpr int T_ = 16384, S_ = 8192, D_ = 1024;
constexpr int IN_DIM = 3104;
constexpr float DN_ALPHA = 1.189207115002721f;
constexpr float LN_EPS = 1e-5f, RMS_EPS = 1e-6f;

constexpr size_t MiB = 1u << 20;
constexpr size_t WS_XN = 0;
constexpr size_t WS_G = 32 * MiB;
constexpr size_t WS_PQ = 32 * MiB;
constexpr size_t WS_ZF = 96 * MiB;
constexpr size_t WS_CQ = 112 * MiB;
constexpr size_t WS_CKV = 120 * MiB;
constexpr size_t WS_KR = 128 * MiB;
constexpr size_t WS_Q = 130 * MiB;
constexpr size_t WS_KN = 154 * MiB;
constexpr size_t WS_V = 170 * MiB;
constexpr size_t WS_O = 186 * MiB;
constexpr size_t WS_Y = 202 * MiB;
constexpr size_t WS_AR = 218 * MiB;
constexpr size_t WS_AI = 234 * MiB;
constexpr size_t WS_CQRAW = 130 * MiB;
constexpr size_t WS_CKVRAW = 146 * MiB;
constexpr size_t WS_KRRAW = 162 * MiB;
constexpr size_t WS_QRAW = 186 * MiB;
constexpr size_t WS_FSR = 96 * MiB;
constexpr size_t WS_FSI = 128 * MiB;
constexpr size_t WS_TMP = 96 * MiB;
constexpr size_t WS_M = 218 * MiB;
constexpr size_t WS_EID = 96 * MiB;
constexpr size_t WS_GATE = 104 * MiB;

__device__ __forceinline__ float bf2f(bf16_t v) { return __uint_as_float(((unsigned)v) << 16); }
__device__ __forceinline__ bf16_t f2bf(float f) { unsigned u = __float_as_uint(f); return (bf16_t)((u + 0x7fffu + ((u >> 16) & 1u)) >> 16); }
__device__ __forceinline__ float wave_sum(float v) {
#pragma unroll
    for (int o = 1; o < 64; o <<= 1) v += __shfl_xor(v, o);
    return v;
}
__device__ __forceinline__ float wave_max(float v) {
#pragma unroll
    for (int o = 1; o < 64; o <<= 1) v = fmaxf(v, __shfl_xor(v, o));
    return v;
}
__device__ __forceinline__ float cos_rev(float rev) { return __builtin_amdgcn_cosf(rev - floorf(rev)); }
__device__ __forceinline__ float sin_rev(float rev) { return __builtin_amdgcn_sinf(rev - floorf(rev)); }
__device__ __forceinline__ float rope_rev(int pos, int i) {
    const float inv = exp2f(-(float)i * (13.287712379549449f / 16.0f));
    return (float)pos * inv * 0.15915494309189535f;
}

__global__ __launch_bounds__(256) void ln_rows_f32(const float* __restrict__ X, const float* __restrict__ g, const float* __restrict__ b, bf16_t* __restrict__ out) {
    const int wave = threadIdx.x >> 6, lane = threadIdx.x & 63;
    const int row = blockIdx.x * 4 + wave;
    const float4* xr = (const float4*)(X + (size_t)row * 1024);
    float4 v[4]; float s = 0.f;
#pragma unroll
    for (int j = 0; j < 4; ++j) { v[j] = xr[lane + 64 * j]; s += (v[j].x + v[j].y) + (v[j].z + v[j].w); }
    const float mean = wave_sum(s) * (1.f / 1024.f);
    float s2 = 0.f;
#pragma unroll
    for (int j = 0; j < 4; ++j) { v[j].x -= mean; v[j].y -= mean; v[j].z -= mean; v[j].w -= mean; s2 += (v[j].x * v[j].x + v[j].y * v[j].y) + (v[j].z * v[j].z + v[j].w * v[j].w); }
    const float rstd = 1.0f / sqrtf(wave_sum(s2) * (1.f / 1024.f) + LN_EPS);
#pragma unroll
    for (int j = 0; j < 4; ++j) {
        const int c = (lane + 64 * j) * 4;
        const float4 gg = *(const float4*)(g + c), bb = *(const float4*)(b + c);
        bf16_t* o = out + (size_t)row * 1024 + c;
        o[0] = f2bf(v[j].x * rstd * gg.x + bb.x); o[1] = f2bf(v[j].y * rstd * gg.y + bb.y);
        o[2] = f2bf(v[j].z * rstd * gg.z + bb.z); o[3] = f2bf(v[j].w * rstd * gg.w + bb.w);
    }
}

template <class Epi>
__global__ __launch_bounds__(256) void gemm_naive(const bf16_t* __restrict__ A, int lda, const float* __restrict__ W, int ldw, int N, int K, Epi epi) {
    __shared__ float As[16][65];
    __shared__ float Ws[16][65];
    const int tx = threadIdx.x & 15, ty = threadIdx.x >> 4;
    const int row0 = blockIdx.y * 64, col0 = blockIdx.x * 64;
    float acc[4][4];
#pragma unroll
    for (int i = 0; i < 4; ++i)
#pragma unroll
        for (int j = 0; j < 4; ++j) acc[i][j] = 0.f;
    for (int k0 = 0; k0 < K; k0 += 16) {
#pragma unroll
        for (int i = 0; i < 4; ++i) { const int idx = threadIdx.x + i * 256; const int r = idx >> 4, kk = idx & 15; As[kk][r] = bf2f(A[(size_t)(row0 + r) * lda + k0 + kk]); }
#pragma unroll
        for (int i = 0; i < 4; ++i) { const int idx = threadIdx.x + i * 256; const int kk = idx >> 6, c = idx & 63; const int gc = col0 + c; Ws[kk][c] = gc < N ? W[(size_t)(k0 + kk) * ldw + gc] : 0.f; }
        __syncthreads();
#pragma unroll
        for (int kk = 0; kk < 16; ++kk) {
            float a[4], b[4];
#pragma unroll
            for (int i = 0; i < 4; ++i) { a[i] = As[kk][ty * 4 + i]; b[i] = Ws[kk][tx * 4 + i]; }
#pragma unroll
            for (int i = 0; i < 4; ++i)
#pragma unroll
                for (int j = 0; j < 4; ++j) acc[i][j] += a[i] * b[j];
        }
        __syncthreads();
    }
#pragma unroll
    for (int i = 0; i < 4; ++i)
#pragma unroll
        for (int j = 0; j < 4; ++j) { const int r = row0 + ty * 4 + i, c = col0 + tx * 4 + j; if (c < N) epi(r, c, acc[i][j]); }
}

struct EpiInproj {
    const float* bias; float* cqraw; float* ckvraw; float* krraw; bf16_t* zf; bf16_t* g;
    __device__ __forceinline__ void operator()(int r, int c, float v) const {
        v += bias[c];
        if (c < 256) cqraw[(size_t)r * 256 + c] = v;
        else if (c < 512) ckvraw[(size_t)r * 256 + (c - 256)] = v;
        else if (c < 544) krraw[(size_t)r * 32 + (c - 512)] = v;
        else if (c < 1056) zf[(size_t)r * 512 + (c - 544)] = f2bf(v);
        else g[(size_t)r * 2048 + (c - 1056)] = f2bf(1.0f / (1.0f + __expf(-v)));
    }
};
struct EpiF32 { float* out; int ld; __device__ __forceinline__ void operator()(int r, int c, float v) const { out[(size_t)r * ld + c] = v; } };
struct EpiBf16 { bf16_t* out; int ld; __device__ __forceinline__ void operator()(int r, int c, float v) const { out[(size_t)r * ld + c] = f2bf(v); } };
struct EpiMerge {
    const float* ya; const bf16_t* g; bf16_t* m;
    __device__ __forceinline__ void operator()(int r, int c, float v) const {
        const float g0 = bf2f(g[(size_t)r * 2048 + c]), g1 = bf2f(g[(size_t)r * 2048 + 1024 + c]);
        m[(size_t)r * 1024 + c] = f2bf(g0 * ya[(size_t)r * 1024 + c] + g1 * v);
    }
};
struct EpiOut {
    const bf16_t* h0; const float* bias; float* tmp;
    __device__ __forceinline__ void operator()(int r, int c, float v) const { tmp[(size_t)r * 1024 + c] = DN_ALPHA * bf2f(h0[(size_t)r * 1024 + c]) + v + bias[c]; }
};

__global__ __launch_bounds__(256) void rms_rope_rows(const float* __restrict__ cqraw, const float* __restrict__ ckvraw, const float* __restrict__ krraw,
                                                     const float* __restrict__ gq, const float* __restrict__ gkv, bf16_t* __restrict__ cq, bf16_t* __restrict__ ckv, bf16_t* __restrict__ kr) {
    const int wave = threadIdx.x >> 6, lane = threadIdx.x & 63;
    const int t = blockIdx.x * 4 + wave;
    {
        const float4 v = *(const float4*)(cqraw + (size_t)t * 256 + lane * 4);
        const float ss = wave_sum(v.x * v.x + v.y * v.y + v.z * v.z + v.w * v.w);
        const float rstd = 1.0f / sqrtf(ss * (1.f / 256.f) + RMS_EPS);
        const float4 gg = *(const float4*)(gq + lane * 4);
        bf16_t* o = cq + (size_t)t * 256 + lane * 4;
        o[0] = f2bf(v.x * rstd * gg.x); o[1] = f2bf(v.y * rstd * gg.y); o[2] = f2bf(v.z * rstd * gg.z); o[3] = f2bf(v.w * rstd * gg.w);
    }
    {
        const float4 v = *(const float4*)(ckvraw + (size_t)t * 256 + lane * 4);
        const float ss = wave_sum(v.x * v.x + v.y * v.y + v.z * v.z + v.w * v.w);
        const float rstd = 1.0f / sqrtf(ss * (1.f / 256.f) + RMS_EPS);
        const float4 gg = *(const float4*)(gkv + lane * 4);
        bf16_t* o = ckv + (size_t)t * 256 + lane * 4;
        o[0] = f2bf(v.x * rstd * gg.x); o[1] = f2bf(v.y * rstd * gg.y); o[2] = f2bf(v.z * rstd * gg.z); o[3] = f2bf(v.w * rstd * gg.w);
    }
    if (lane < 16) {
        const int pos = t & (S_ - 1);
        const float rev = rope_rev(pos, lane);
        const float c = cos_rev(rev), s = sin_rev(rev);
        const float x1 = krraw[(size_t)t * 32 + lane], x2 = krraw[(size_t)t * 32 + 16 + lane];
        kr[(size_t)t * 32 + lane] = f2bf(x1 * c - x2 * s);
        kr[(size_t)t * 32 + 16 + lane] = f2bf(x2 * c + x1 * s);
    }
}

__global__ __launch_bounds__(256) void q_rope(const float* __restrict__ qraw, bf16_t* __restrict__ q) {
    const size_t idx = (size_t)blockIdx.x * 256 + threadIdx.x;
    const int t = (int)(idx / 768), c = (int)(idx % 768);
    const int h = c / 96, d = c % 96;
    const float scale = 0.10206207261596577f;
    float v;
    if (d < 64) v = qraw[idx];
    else {
        const int i = (d - 64) & 15; const int pos = t & (S_ - 1);
        const float rev = rope_rev(pos, i);
        const float cs = cos_rev(rev), sn = sin_rev(rev);
        const float x1 = qraw[(size_t)t * 768 + h * 96 + 64 + i], x2 = qraw[(size_t)t * 768 + h * 96 + 80 + i];
        v = (d < 80) ? (x1 * cs - x2 * sn) : (x2 * cs + x1 * sn);
    }
    q[idx] = f2bf(v * scale);
}

__global__ __launch_bounds__(128) void attn_naive(const bf16_t* __restrict__ Q, const bf16_t* __restrict__ KN, const bf16_t* __restrict__ KR, const bf16_t* __restrict__ V, bf16_t* __restrict__ O) {
    __shared__ float Ks[32][96];
    __shared__ float Vs[32][64];
    const int b = blockIdx.z, h = blockIdx.y, q0 = blockIdx.x * 128, tid = threadIdx.x;
    const size_t t = (size_t)b * S_ + q0 + tid;
    float q[96];
#pragma unroll
    for (int d = 0; d < 96; ++d) q[d] = bf2f(Q[t * 768 + h * 96 + d]);
    float o[64];
#pragma unroll
    for (int d = 0; d < 64; ++d) o[d] = 0.f;
    float m = -1e30f, l = 0.f;
    for (int kt = 0; kt < S_; kt += 32) {
        __syncthreads();
        for (int i = tid; i < 32 * 96; i += 128) { const int j = i / 96, d = i % 96; const size_t tk = (size_t)b * S_ + kt + j; Ks[j][d] = d < 64 ? bf2f(KN[tk * 512 + h * 64 + d]) : bf2f(KR[tk * 32 + (d - 64)]); }
        for (int i = tid; i < 32 * 64; i += 128) { const int j = i / 64, d = i % 64; const size_t tk = (size_t)b * S_ + kt + j; Vs[j][d] = bf2f(V[tk * 512 + h * 64 + d]); }
        __syncthreads();
        float s[32]; float mx = -1e30f;
#pragma unroll
        for (int j = 0; j < 32; ++j) {
            float a = 0.f;
#pragma unroll
            for (int d = 0; d < 96; ++d) a += q[d] * Ks[j][d];
            s[j] = a; mx = fmaxf(mx, a);
        }
        const float mn = fmaxf(m, mx);
        const float corr = __expf(m - mn);
        m = mn; l *= corr;
#pragma unroll
        for (int d = 0; d < 64; ++d) o[d] *= corr;
#pragma unroll
        for (int j = 0; j < 32; ++j) {
            const float p = __expf(s[j] - mn); l += p;
#pragma unroll
            for (int d = 0; d < 64; ++d) o[d] += p * Vs[j][d];
        }
    }
    const float rl = 1.0f / l;
#pragma unroll
    for (int d = 0; d < 64; ++d) O[t * 512 + h * 64 + d] = f2bf(o[d] * rl);
}

__global__ __launch_bounds__(256) void fourier_a(const bf16_t* __restrict__ ZF, bf16_t* __restrict__ AR, bf16_t* __restrict__ AI) {
    const size_t idx = (size_t)blockIdx.x * 256 + threadIdx.x;
    const int c = (int)(idx & 511), n2 = (int)((idx >> 9) & 127), k1 = (int)((idx >> 16) & 63), b = (int)(idx >> 22);
    float re = 0.f, im = 0.f;
    for (int n1 = 0; n1 < 64; ++n1) {
        const float z = bf2f(ZF[((size_t)b * S_ + 128 * n1 + n2) * 512 + c]);
        const float rev = (float)((n1 * k1) & 63) * (1.f / 64.f);
        re += z * cos_rev(rev); im -= z * sin_rev(rev);
    }
    const float rev = (float)(n2 * k1) * (1.f / 8192.f);
    const float cs = cos_rev(rev), sn = sin_rev(rev);
    AR[idx] = f2bf(re * cs + im * sn);
    AI[idx] = f2bf(im * cs - re * sn);
}
__global__ __launch_bounds__(256) void fourier_c1(const bf16_t* __restrict__ AR, const bf16_t* __restrict__ AI, float* __restrict__ FSR, float* __restrict__ FSI) {
    const size_t idx = (size_t)blockIdx.x * 256 + threadIdx.x;
    const int c = (int)(idx & 511), k2 = (int)((idx >> 9) & 127), k1 = (int)((idx >> 16) & 63), b = (int)(idx >> 22);
    float re = 0.f, im = 0.f;
    for (int n2 = 0; n2 < 128; ++n2) {
        const size_t a = ((((size_t)b * 64 + k1) * 128) + n2) * 512 + c;
        const float ar = bf2f(AR[a]), ai = bf2f(AI[a]);
        const float rev = (float)((n2 * k2) & 127) * (1.f / 128.f);
        const float cs = cos_rev(rev), sn = sin_rev(rev);
        re += ar * cs + ai * sn; im += ai * cs - ar * sn;
    }
    const size_t o = ((size_t)b * S_ + k1 + 64 * k2) * 512 + c;
    FSR[o] = re; FSI[o] = im;
}
__global__ __launch_bounds__(256) void fourier_c2(const float* __restrict__ FSR, const float* __restrict__ FSI, bf16_t* __restrict__ Y) {
    const size_t idx = (size_t)blockIdx.x * 256 + threadIdx.x;
    const int col = (int)(idx & 511); const size_t t = idx >> 9;
    const int g = col >> 7, kc = col & 127;
    float acc = 0.f;
    for (int nc = 0; nc < 128; ++nc) {
        const float rev = (float)((nc * kc) & 127) * (1.f / 128.f);
        acc += FSR[t * 512 + g * 128 + nc] * cos_rev(rev) + FSI[t * 512 + g * 128 + nc] * sin_rev(rev);
    }
    Y[idx] = f2bf(acc * (1.f / 1024.f));
}

__device__ __forceinline__ unsigned ord_f32(float f) { const unsigned u = __float_as_uint(f); return (u & 0x80000000u) ? ~u : (u | 0x80000000u); }
__device__ __forceinline__ float unord_f32(unsigned k) { const unsigned u = (k & 0x80000000u) ? (k & 0x7fffffffu) : ~k; return __uint_as_float(u); }
template <int NV>
__device__ __forceinline__ void wave_top16(const float (&v)[NV], int lane, float& topv, int& topi) {
    unsigned key[NV];
#pragma unroll
    for (int k = 0; k < NV; ++k) key[k] = ord_f32(v[k]);
    topv = 0.f; topi = 0;
    for (int r = 0; r < 16; ++r) {
        unsigned bk = 0u, bi = 0u;
#pragma unroll
        for (int k = 0; k < NV; ++k) { const unsigned ii = 0xFFFFu - (unsigned)(lane + 64 * k); if (key[k] > bk || (key[k] == bk && ii > bi)) { bk = key[k]; bi = ii; } }
#pragma unroll
        for (int o = 1; o < 64; o <<= 1) {
            const unsigned ok = (unsigned)__shfl_xor((int)bk, o), oi = (unsigned)__shfl_xor((int)bi, o);
            if (ok > bk || (ok == bk && oi > bi)) { bk = ok; bi = oi; }
        }
        const int widx = (int)(0xFFFFu - bi);
        if (lane == r) { topv = unord_f32(bk); topi = widx; }
#pragma unroll
        for (int k = 0; k < NV; ++k) if (lane + 64 * k == widx) key[k] = 0u;
    }
}
__global__ __launch_bounds__(256) void peer_select_naive(const bf16_t* __restrict__ PQ, const float* __restrict__ keys, int* __restrict__ EID, float* __restrict__ GATE) {
    __shared__ float qs[4][256];
    const int wave = threadIdx.x >> 6, lane = threadIdx.x & 63;
    const int item = blockIdx.x * 4 + wave;
    const int t = item >> 3, h = item & 7;
#pragma unroll
    for (int j = 0; j < 4; ++j) qs[wave][lane + 64 * j] = bf2f(PQ[(size_t)t * 2048 + h * 256 + lane + 64 * j]);
    __syncthreads();
    float s0[2], s1[2];
#pragma unroll
    for (int k = 0; k < 2; ++k) {
        const int n = lane + 64 * k;
        const float4* k0 = (const float4*)(keys + ((size_t)(h * 2 + 0) * 128 + n) * 128);
        const float4* k1 = (const float4*)(keys + ((size_t)(h * 2 + 1) * 128 + n) * 128);
        float a0 = 0.f, a1 = 0.f;
#pragma unroll 2
        for (int d = 0; d < 32; ++d) {
            const float4 x = k0[d], y = k1[d];
            a0 += qs[wave][4 * d] * x.x + qs[wave][4 * d + 1] * x.y + qs[wave][4 * d + 2] * x.z + qs[wave][4 * d + 3] * x.w;
            a1 += qs[wave][128 + 4 * d] * y.x + qs[wave][128 + 4 * d + 1] * y.y + qs[wave][128 + 4 * d + 2] * y.z + qs[wave][128 + 4 * d + 3] * y.w;
        }
        s0[k] = a0; s1[k] = a1;
    }
    float sv0, sv1; int si0, si1;
    wave_top16<2>(s0, lane, sv0, si0);
    wave_top16<2>(s1, lane, sv1, si1);
    float cand[4];
#pragma unroll
    for (int k = 0; k < 4; ++k) { const int ci = lane + 64 * k; cand[k] = __shfl(sv0, ci >> 4) + __shfl(sv1, ci & 15); }
    float cv; int ci;
    wave_top16<4>(cand, lane, cv, ci);
    ci &= 255;
    const int ia = __shfl(si0, ci >> 4), ib = __shfl(si1, ci & 15);
    const float mx = __shfl(cv, 0);
    float e = (lane < 16) ? __expf(cv - mx) : 0.f;
    float sum = e;
#pragma unroll
    for (int o = 1; o < 16; o <<= 1) sum += __shfl_xor(sum, o);
    if (lane < 16) { EID[(size_t)t * 128 + h * 16 + lane] = ia * 128 + ib; GATE[(size_t)t * 128 + h * 16 + lane] = e / sum; }
}

__global__ __launch_bounds__(256) void peer_gather_naive(const bf16_t* __restrict__ H1, const int* __restrict__ EID, const float* __restrict__ GATE, const float* __restrict__ WU, const float* __restrict__ WV,
                                                         const float* __restrict__ g2, const float* __restrict__ b2, float* __restrict__ out) {
    const int wave = threadIdx.x >> 6, lane = threadIdx.x & 63;
    const int t = blockIdx.x * 4 + wave;
    float4 x[4], y[4];
#pragma unroll
    for (int j = 0; j < 4; ++j) {
        const bf16_t* p = H1 + (size_t)t * 1024 + (lane + 64 * j) * 4;
        x[j] = make_float4(bf2f(p[0]), bf2f(p[1]), bf2f(p[2]), bf2f(p[3]));
        y[j] = make_float4(0.f, 0.f, 0.f, 0.f);
    }
    for (int e = 0; e < 128; ++e) {
        const int id = EID[(size_t)t * 128 + e]; const float gate = GATE[(size_t)t * 128 + e];
        const float4* ur = (const float4*)(WU + (size_t)id * 1024);
        float dsum = 0.f;
#pragma unroll
        for (int j = 0; j < 4; ++j) { const float4 u = ur[lane + 64 * j]; dsum += (u.x * x[j].x + u.y * x[j].y) + (u.z * x[j].z + u.w * x[j].w); }
        const float hh = wave_sum(dsum);
        const float a = 0.5f * hh * (1.0f + erff(hh * 0.7071067811865476f)) * gate;
        const float4* vr = (const float4*)(WV + (size_t)id * 1024);
#pragma unroll
        for (int j = 0; j < 4; ++j) { const float4 w = vr[lane + 64 * j]; y[j].x += a * w.x; y[j].y += a * w.y; y[j].z += a * w.z; y[j].w += a * w.w; }
    }
    float s = 0.f;
#pragma unroll
    for (int j = 0; j < 4; ++j) { y[j].x += DN_ALPHA * x[j].x; y[j].y += DN_ALPHA * x[j].y; y[j].z += DN_ALPHA * x[j].z; y[j].w += DN_ALPHA * x[j].w; s += (y[j].x + y[j].y) + (y[j].z + y[j].w); }
    const float mean = wave_sum(s) * (1.f / 1024.f);
    float s2 = 0.f;
#pragma unroll
    for (int j = 0; j < 4; ++j) { y[j].x -= mean; y[j].y -= mean; y[j].z -= mean; y[j].w -= mean; s2 += (y[j].x * y[j].x + y[j].y * y[j].y) + (y[j].z * y[j].z + y[j].w * y[j].w); }
    const float rstd = 1.0f / sqrtf(wave_sum(s2) * (1.f / 1024.f) + LN_EPS);
#pragma unroll
    for (int j = 0; j < 4; ++j) {
        const int c = (lane + 64 * j) * 4;
        const float4 gg = *(const float4*)(g2 + c), bb = *(const float4*)(b2 + c);
        float4 o; o.x = y[j].x * rstd * gg.x + bb.x; o.y = y[j].y * rstd * gg.y + bb.y; o.z = y[j].z * rstd * gg.z + bb.z; o.w = y[j].w * rstd * gg.w + bb.w;
        *(float4*)(out + (size_t)t * 1024 + c) = o;
    }
}

extern "C" void kernel_launch(void* const* d_in, const int* in_sizes, int n_in, void* d_out, int out_size, void* d_ws, size_t ws_size, hipStream_t stream) {
    const float* x = (const float*)d_in[0];
    const float* ln0_g = (const float*)d_in[1]; const float* ln0_b = (const float*)d_in[2];
    const float* w_in = (const float*)d_in[3]; const float* b_in = (const float*)d_in[4];
    const float* q_norm_g = (const float*)d_in[5]; const float* kv_norm_g = (const float*)d_in[6];
    const float* w_uq = (const float*)d_in[7]; const float* w_uk = (const float*)d_in[8]; const float* w_uv = (const float*)d_in[9];
    const float* w_o_attn = (const float*)d_in[10]; const float* w_fourier = (const float*)d_in[11];
    const float* w_out = (const float*)d_in[12]; const float* b_out = (const float*)d_in[13];
    const float* ln1_g = (const float*)d_in[14]; const float* ln1_b = (const float*)d_in[15];
    const float* peer_w_q = (const float*)d_in[16]; const float* peer_keys = (const float*)d_in[17];
    const float* peer_w_u = (const float*)d_in[18]; const float* peer_w_v = (const float*)d_in[19];
    const float* ln2_g = (const float*)d_in[20]; const float* ln2_b = (const float*)d_in[21];
    float* out = (float*)d_out;
    char* ws = (char*)d_ws;
    bf16_t* XN = (bf16_t*)(ws + WS_XN); bf16_t* G = (bf16_t*)(ws + WS_G); bf16_t* PQ = (bf16_t*)(ws + WS_PQ); bf16_t* ZF = (bf16_t*)(ws + WS_ZF);
    bf16_t* CQ = (bf16_t*)(ws + WS_CQ); bf16_t* CKV = (bf16_t*)(ws + WS_CKV); bf16_t* KR = (bf16_t*)(ws + WS_KR);
    bf16_t* Q = (bf16_t*)(ws + WS_Q); bf16_t* KN = (bf16_t*)(ws + WS_KN); bf16_t* V = (bf16_t*)(ws + WS_V); bf16_t* O = (bf16_t*)(ws + WS_O);
    bf16_t* Y = (bf16_t*)(ws + WS_Y); bf16_t* AR = (bf16_t*)(ws + WS_AR); bf16_t* AI = (bf16_t*)(ws + WS_AI); bf16_t* M = (bf16_t*)(ws + WS_M);
    float* CQRAW = (float*)(ws + WS_CQRAW); float* CKVRAW = (float*)(ws + WS_CKVRAW); float* KRRAW = (float*)(ws + WS_KRRAW); float* QRAW = (float*)(ws + WS_QRAW);
    float* FSR = (float*)(ws + WS_FSR); float* FSI = (float*)(ws + WS_FSI); float* TMP = (float*)(ws + WS_TMP);
    int* EID = (int*)(ws + WS_EID); float* GATE = (float*)(ws + WS_GATE);

    ln_rows_f32<<<T_ / 4, 256, 0, stream>>>(x, ln0_g, ln0_b, XN);
    gemm_naive<EpiInproj><<<dim3((IN_DIM + 63) / 64, T_ / 64), 256, 0, stream>>>(XN, 1024, w_in, IN_DIM, IN_DIM, 1024, EpiInproj{b_in, CQRAW, CKVRAW, KRRAW, ZF, G});
    rms_rope_rows<<<T_ / 4, 256, 0, stream>>>(CQRAW, CKVRAW, KRRAW, q_norm_g, kv_norm_g, CQ, CKV, KR);
    gemm_naive<EpiF32><<<dim3(768 / 64, T_ / 64), 256, 0, stream>>>(CQ, 256, w_uq, 768, 768, 256, EpiF32{QRAW, 768});
    q_rope<<<(T_ * 768) / 256, 256, 0, stream>>>(QRAW, Q);
    gemm_naive<EpiBf16><<<dim3(512 / 64, T_ / 64), 256, 0, stream>>>(CKV, 256, w_uk, 512, 512, 256, EpiBf16{KN, 512});
    gemm_naive<EpiBf16><<<dim3(512 / 64, T_ / 64), 256, 0, stream>>>(CKV, 256, w_uv, 512, 512, 256, EpiBf16{V, 512});
    fourier_a<<<(2 * 64 * 128 * 512) / 256, 256, 0, stream>>>(ZF, AR, AI);
    attn_naive<<<dim3(S_ / 128, 8, 2), 128, 0, stream>>>(Q, KN, KR, V, O);
    fourier_c1<<<(2 * 64 * 128 * 512) / 256, 256, 0, stream>>>(AR, AI, FSR, FSI);
    fourier_c2<<<(T_ * 512) / 256, 256, 0, stream>>>(FSR, FSI, Y);
    gemm_naive<EpiF32><<<dim3(1024 / 64, T_ / 64), 256, 0, stream>>>(O, 512, w_o_attn, 1024, 1024, 512, EpiF32{TMP, 1024});
    gemm_naive<EpiMerge><<<dim3(1024 / 64, T_ / 64), 256, 0, stream>>>(Y, 512, w_fourier, 1024, 1024, 512, EpiMerge{TMP, G, M});
    gemm_naive<EpiOut><<<dim3(1024 / 64, T_ / 64), 256, 0, stream>>>(M, 1024, w_out, 1024, 1024, 1024, EpiOut{XN, b_out, TMP});
    ln_rows_f32<<<T_ / 4, 256, 0, stream>>>(TMP, ln1_g, ln1_b, XN);
    gemm_naive<EpiBf16><<<dim3(2048 / 64, T_ / 64), 256, 0, stream>>>(XN, 1024, peer_w_q, 2048, 2048, 1024, EpiBf16{PQ, 2048});
    peer_select_naive<<<(T_ * 8) / 4, 256, 0, stream>>>(PQ, peer_keys, EID, GATE);
    peer_gather_naive<<<T_ / 4, 256, 0, stream>>>(XN, EID, GATE, peer_w_u, peer_w_v, ln2_g, ln2_b, out);
}
```
